# Optimizing an MI355X kernel written in HIP

```python
import jax, jax.numpy as jnp
from jax import lax
import numpy as np

D_MODEL = 1024
BATCH = 8
SEQ = 2048
DEPTH = 4
DEC_BATCH = 32
DEC_SEQ = 8
PAST_LEN = 16384
PAGE_SIZE = 128

GLA_HEADS = 4
GLA_DK = 32
GLA_DV = 64
GLA_WIDTH = GLA_HEADS * GLA_DV
GLA_LOWRANK = 16
GLA_GATE_TAU = 16.0
GLA_CHUNK = 32
LRU_WIDTH = 256
LRU_BLOCKS = 4
LRU_BLOCK_W = LRU_WIDTH // LRU_BLOCKS
CONV_WIDTH = 4
LRU_C = 8.0
MLA_HEADS = 8
MLA_NOPE = 64
MLA_ROPE = 32
MLA_V = 64
MLA_WIDTH = MLA_HEADS * MLA_V
MLA_Q_LORA = 256
MLA_KV_LORA = 128
ROPE_THETA = 10000.0
ATTN_Q_BLOCK = 128
MIX_WIDTH = GLA_WIDTH + LRU_WIDTH + MLA_WIDTH
D_FF = -(-8 * D_MODEL // (3 * 256)) * 256
DEEPNORM_ALPHA = (2.0 * DEPTH) ** 0.25
DEEPNORM_BETA = (8.0 * DEPTH) ** -0.25
IN_SIZES = (GLA_HEADS * GLA_DK, GLA_HEADS * GLA_DK, GLA_WIDTH, GLA_WIDTH, GLA_LOWRANK,
            LRU_WIDTH, LRU_WIDTH, MLA_Q_LORA, MLA_KV_LORA, MLA_ROPE)
IN_COLS = sum(IN_SIZES)

kernel_name = 'hybrid_gla_rglru_mla_deepnorm_adaln_step'


def _layer_norm(x, g, b, eps=1e-5):
    xf = x.astype(jnp.float32)
    mu = jnp.mean(xf, -1, keepdims=True)
    var = jnp.mean(jnp.square(xf - mu), -1, keepdims=True)
    return ((xf - mu) * lax.rsqrt(var + eps) * g + b).astype(x.dtype)


def _rms_norm(x, g, eps=1e-6):
    xf = x.astype(jnp.float32)
    return (xf * lax.rsqrt(jnp.mean(xf * xf, -1, keepdims=True) + eps) * g).astype(x.dtype)


def _rope(x, pos):
    half = MLA_ROPE // 2
    inv_freq = ROPE_THETA ** (-jnp.arange(half, dtype=jnp.float32) / half)
    ang = pos.astype(jnp.float32)[:, None] * inv_freq[None, :]
    ang = ang.reshape(ang.shape[0], *([1] * (x.ndim - 3)), half)
    cos, sin = jnp.cos(ang), jnp.sin(ang)
    xf = x.astype(jnp.float32)
    x1, x2 = xf[..., :half], xf[..., half:]
    return jnp.concatenate([x1 * cos - x2 * sin, x2 * cos + x1 * sin], -1).astype(x.dtype)


def _gla(q, k, v, logf, s0):
    B, T = q.shape[:2]
    C = GLA_CHUNK if T % GLA_CHUNK == 0 else T
    n = T // C

    def to_chunks(a):
        return a.astype(jnp.float32).reshape(B, n, C, *a.shape[2:]).transpose(1, 0, 3, 2, 4)

    causal = jnp.tril(jnp.ones((C, C), dtype=bool))[:, :, None]

    def step(s, inp):
        qb, kb, vb, gb = inp
        bcum = jnp.cumsum(gb, axis=2)
        diff = bcum[:, :, :, None, :] - bcum[:, :, None, :, :]
        decay = jnp.exp(jnp.where(causal, diff, -jnp.inf))
        attn = jnp.einsum('bhtk,bhsk,bhtsk->bhts', qb, kb, decay)
        o = jnp.einsum('bhts,bhsv->bhtv', attn, vb) + jnp.einsum('bhtk,bhkv->bhtv', qb * jnp.exp(bcum), s)
        b_last = bcum[:, :, -1:, :]
        s_new = jnp.exp(b_last[:, :, 0, :])[..., None] * s + jnp.einsum('bhsk,bhsv->bhkv', kb * jnp.exp(b_last - bcum), vb)
        return s_new, o

    s_fin, o = lax.scan(step, s0.astype(jnp.float32), (to_chunks(q), to_chunks(k), to_chunks(v), to_chunks(logf)))
    o = o.transpose(1, 0, 3, 2, 4).reshape(B, T, GLA_HEADS, GLA_DV)
    return o.astype(q.dtype), s_fin.astype(s0.dtype)


def _causal_conv(x, buf, w, b):
    T = x.shape[1]
    xp = jnp.concatenate([buf.astype(x.dtype), x], axis=1)
    y = b
    for kk in range(CONV_WIDTH):
        y = y + xp[:, kk:kk + T] * w[kk]
    return y, xp[:, T:]


def _block_diag(x, w):
    B, T, _ = x.shape
    return jnp.einsum('btnj,njk->btnk', x.reshape(B, T, LRU_BLOCKS, LRU_BLOCK_W), w).reshape(B, T, LRU_WIDTH)


def _rg_lru(x, h0, w_a, b_a, w_x, b_x, lam):
    xf = x.astype(jnp.float32)
    r = jax.nn.sigmoid((_block_diag(x, w_a) + b_a).astype(jnp.float32))
    i = jax.nn.sigmoid((_block_diag(x, w_x) + b_x).astype(jnp.float32))
    log_a = -LRU_C * r * jax.nn.softplus(-lam.astype(jnp.float32))
    a = jnp.exp(log_a)
    u = jnp.sqrt(-jnp.expm1(2.0 * log_a)) * (i * xf)
    u = u.at[:, 0].add(a[:, 0] * h0.astype(jnp.float32))

    def combine(lhs, rhs):
        a1, b1 = lhs
        a2, b2 = rhs
        return a1 * a2, a2 * b1 + b2

    _, h = lax.associative_scan(combine, (a, u), axis=1)
    return h.astype(x.dtype), h[:, -1].astype(h0.dtype)


def _mla_attend(q_lat, q_rope, ckv, kr, q_pos):
    B, T, H, L = q_lat.shape
    S = ckv.shape[1]
    qb = ATTN_Q_BLOCK if T % ATTN_Q_BLOCK == 0 else T
    nb = T // qb
    k_pos = jnp.arange(S, dtype=jnp.int32)
    scale = (MLA_NOPE + MLA_ROPE) ** -0.5

    def blocks(a):
        return a.reshape(B, nb, qb, *a.shape[2:]).swapaxes(0, 1)

    def one_block(args):
        ql, qr, qp = args
        s = (jnp.einsum('bqhl,bsl->bhqs', ql, ckv) + jnp.einsum('bqhr,bsr->bhqs', qr, kr)).astype(jnp.float32) * scale
        s = jnp.where((k_pos[None, :] <= qp[:, None])[None, None], s, -jnp.inf)
        p = jax.nn.softmax(s, axis=-1).astype(ckv.dtype)
        return jnp.einsum('bhqs,bsl->bqhl', p, ckv)

    o = lax.map(one_block, (blocks(q_lat), blocks(q_rope), q_pos.reshape(nb, qb)))
    return o.swapaxes(0, 1).reshape(B, T, H, L)


def _layer(x, ada, pos, s_gla, h_lru, conv_buf, past_ckv, past_kr, lw):
    (w_in, gla_w_gate, gla_b_gate, gla_norm_g, conv_w, conv_b, lru_w_a, lru_b_a, lru_w_x, lru_b_x, lru_lambda,
     mla_q_norm_g, mla_w_uq, mla_kv_norm_g, mla_w_uk, mla_w_uv, w_out, ln1_g, ln1_b,
     ffn_w_gu, ffn_w_down, ln2_g, ln2_b) = lw
    B, T, _ = x.shape
    shift1, scale1, gate1, shift2, scale2, gate2 = [a[:, None, :] for a in jnp.split(ada, 6, axis=-1)]

    h = x * (1 + scale1) + shift1
    split_at = [int(v) for v in np.cumsum(IN_SIZES)[:-1]]
    gq, gk, gv, gg, glr, lx, lgate, dq, dkv, kr_raw = jnp.split(h @ w_in, split_at, axis=-1)

    q = gq.reshape(B, T, GLA_HEADS, GLA_DK) * (GLA_DK ** -0.5)
    k = gk.reshape(B, T, GLA_HEADS, GLA_DK)
    v = gv.reshape(B, T, GLA_HEADS, GLA_DV)
    logf = jax.nn.log_sigmoid((glr @ gla_w_gate + gla_b_gate).astype(jnp.float32)) / GLA_GATE_TAU
    o, s_gla_new = _gla(q, k, v, logf.reshape(B, T, GLA_HEADS, GLA_DK), s_gla)
    o_gla = (_rms_norm(o, gla_norm_g) * jax.nn.silu(gg.reshape(B, T, GLA_HEADS, GLA_DV))).reshape(B, T, GLA_WIDTH)

    xc, conv_new = _causal_conv(lx, conv_buf, conv_w, conv_b)
    hseq, h_new = _rg_lru(xc, h_lru, lru_w_a, lru_b_a, lru_w_x, lru_b_x, lru_lambda)
    o_lru = jax.nn.gelu(lgate) * hseq

    q_all = jnp.einsum('btr,rhd->bthd', _rms_norm(dq, mla_q_norm_g), mla_w_uq)
    q_nope = q_all[..., :MLA_NOPE]
    q_rope = _rope(q_all[..., MLA_NOPE:], pos)
    ckv_new = _rms_norm(dkv, mla_kv_norm_g)
    kr_new = _rope(kr_raw, pos)
    if past_ckv is None:
        keys_c, keys_r = ckv_new, kr_new
    else:
        keys_c = jnp.concatenate([past_ckv.astype(x.dtype), ckv_new], axis=1)
        keys_r = jnp.concatenate([past_kr.astype(x.dtype), kr_new], axis=1)
    q_lat = jnp.einsum('bthn,lhn->bthl', q_nope, mla_w_uk)
    o_lat = _mla_attend(q_lat, q_rope, keys_c, keys_r, pos)
    o_mla = jnp.einsum('bthl,lhv->bthv', o_lat, mla_w_uv).reshape(B, T, MLA_WIDTH)

    mix = jnp.concatenate([o_gla, o_lru, o_mla], axis=-1) @ w_out
    x = _layer_norm(DEEPNORM_ALPHA * x + gate1 * mix, ln1_g, ln1_b)

    h2 = x * (1 + scale2) + shift2
    g_ff, u_ff = jnp.split(h2 @ ffn_w_gu, 2, axis=-1)
    f = (jax.nn.silu(g_ff) * u_ff) @ ffn_w_down
    x = _layer_norm(DEEPNORM_ALPHA * x + gate2 * f, ln2_g, ln2_b)
    return x, s_gla_new, h_new, conv_new, ckv_new, kr_new


def setup_inputs(seed: int = 0) -> dict:
    key = jax.random.key(seed)
    ks = iter(jax.random.split(key, 64))
    f32 = jnp.float32

    def nrm(shape, scale=1.0):
        return scale * jax.random.normal(next(ks), shape, f32)

    def gain(shape):
        return 1.0 + nrm(shape, 0.02)

    n_pages = PAST_LEN // PAGE_SIZE
    n_used = DEC_BATCH * n_pages
    n_phys = n_used + max(1, n_used // 4)
    inp = {}
    inp['x_prompt'] = nrm((BATCH, SEQ, D_MODEL))
    inp['x_sample'] = nrm((DEC_BATCH, DEC_SEQ, D_MODEL))
    inp['c_prompt'] = nrm((BATCH, D_MODEL))
    inp['c_sample'] = nrm((DEC_BATCH, D_MODEL))
    inp['state_gla'] = nrm((DEPTH, DEC_BATCH, GLA_HEADS, GLA_DK, GLA_DV), 0.5)
    inp['state_lru'] = nrm((DEPTH, DEC_BATCH, LRU_WIDTH), 0.5)
    inp['state_conv'] = nrm((DEPTH, DEC_BATCH, CONV_WIDTH - 1, LRU_WIDTH))
    inp['cache_ckv'] = nrm((DEPTH, n_phys, PAGE_SIZE, MLA_KV_LORA))
    inp['cache_krope'] = nrm((DEPTH, n_phys, PAGE_SIZE, MLA_ROPE))
    inp['page_table'] = jax.random.permutation(next(ks), n_phys)[:n_used].reshape(DEC_BATCH, n_pages).astype(jnp.int32)
    inp['ln_in_g'] = gain((D_MODEL,))
    inp['ln_in_b'] = nrm((D_MODEL,), 0.02)
    inp['w_ada'] = nrm((DEPTH, D_MODEL, 6 * D_MODEL), 0.5 * D_MODEL ** -0.5)
    inp['b_ada'] = nrm((DEPTH, 6 * D_MODEL), 0.02)
    inp['w_in'] = nrm((DEPTH, D_MODEL, IN_COLS), D_MODEL ** -0.5)
    inp['gla_w_gate'] = nrm((DEPTH, GLA_LOWRANK, GLA_HEADS * GLA_DK), GLA_LOWRANK ** -0.5)
    inp['gla_b_gate'] = nrm((DEPTH, GLA_HEADS * GLA_DK), 0.1)
    inp['gla_norm_g'] = gain((DEPTH, GLA_DV))
    inp['lru_conv_w'] = nrm((DEPTH, CONV_WIDTH, LRU_WIDTH), CONV_WIDTH ** -0.5)
    inp['lru_conv_b'] = nrm((DEPTH, LRU_WIDTH), 0.02)
    inp['lru_w_a'] = nrm((DEPTH, LRU_BLOCKS, LRU_BLOCK_W, LRU_BLOCK_W), LRU_BLOCK_W ** -0.5)
    inp['lru_b_a'] = nrm((DEPTH, LRU_WIDTH), 0.02)
    inp['lru_w_x'] = nrm((DEPTH, LRU_BLOCKS, LRU_BLOCK_W, LRU_BLOCK_W), LRU_BLOCK_W ** -0.5)
    inp['lru_b_x'] = nrm((DEPTH, LRU_WIDTH), 0.02)
    a_c = jax.random.uniform(next(ks), (DEPTH, LRU_WIDTH), f32, 0.9, 0.999)
    sig = a_c ** (1.0 / LRU_C)
    inp['lru_lambda'] = jnp.log(sig) - jnp.log1p(-sig)
    inp['mla_q_norm_g'] = gain((DEPTH, MLA_Q_LORA))
    inp['mla_w_uq'] = nrm((DEPTH, MLA_Q_LORA, MLA_HEADS, MLA_NOPE + MLA_ROPE), MLA_Q_LORA ** -0.5)
    inp['mla_kv_norm_g'] = gain((DEPTH, MLA_KV_LORA))
    inp['mla_w_uk'] = nrm((DEPTH, MLA_KV_LORA, MLA_HEADS, MLA_NOPE), MLA_KV_LORA ** -0.5)
    inp['mla_w_uv'] = nrm((DEPTH, MLA_KV_LORA, MLA_HEADS, MLA_V), MLA_KV_LORA ** -0.5)
    inp['w_out'] = nrm((DEPTH, MIX_WIDTH, D_MODEL), DEEPNORM_BETA * MIX_WIDTH ** -0.5)
    inp['ln1_g'] = gain((DEPTH, D_MODEL))
    inp['ln1_b'] = nrm((DEPTH, D_MODEL), 0.02)
    inp['ffn_w_gu'] = nrm((DEPTH, D_MODEL, 2 * D_FF), D_MODEL ** -0.5)
    inp['ffn_w_down'] = nrm((DEPTH, D_FF, D_MODEL), DEEPNORM_BETA * D_FF ** -0.5)
    inp['ln2_g'] = gain((DEPTH, D_MODEL))
    inp['ln2_b'] = nrm((DEPTH, D_MODEL), 0.02)
    return inp


def reference(x_prompt, x_sample, c_prompt, c_sample, state_gla, state_lru, state_conv, cache_ckv, cache_krope,
              page_table, ln_in_g, ln_in_b, w_ada, b_ada, w_in, gla_w_gate, gla_b_gate, gla_norm_g,
              lru_conv_w, lru_conv_b, lru_w_a, lru_b_a, lru_w_x, lru_b_x, lru_lambda,
              mla_q_norm_g, mla_w_uq, mla_kv_norm_g, mla_w_uk, mla_w_uv, w_out, ln1_g, ln1_b,
              ffn_w_gu, ffn_w_down, ln2_g, ln2_b):
    bp, tp, _ = x_prompt.shape
    bs, ts, _ = x_sample.shape
    n_pages = PAST_LEN // PAGE_SIZE
    dt = x_prompt.dtype
    pos_p = jnp.arange(tp, dtype=jnp.int32)
    pos_s = PAST_LEN + jnp.arange(ts, dtype=jnp.int32)
    zero_gla = jnp.zeros((bp, GLA_HEADS, GLA_DK, GLA_DV), dt)
    zero_h = jnp.zeros((bp, LRU_WIDTH), dt)
    zero_conv = jnp.zeros((bp, CONV_WIDTH - 1, LRU_WIDTH), dt)
    xp = _layer_norm(x_prompt, ln_in_g, ln_in_b)
    xs = _layer_norm(x_sample, ln_in_g, ln_in_b)
    cp = jax.nn.silu(c_prompt)
    cs = jax.nn.silu(c_sample)
    st_p, st_s = [], []
    for l in range(DEPTH):
        lw = (w_in[l], gla_w_gate[l], gla_b_gate[l], gla_norm_g[l], lru_conv_w[l], lru_conv_b[l],
              lru_w_a[l], lru_b_a[l], lru_w_x[l], lru_b_x[l], lru_lambda[l],
              mla_q_norm_g[l], mla_w_uq[l], mla_kv_norm_g[l], mla_w_uk[l], mla_w_uv[l], w_out[l],
              ln1_g[l], ln1_b[l], ffn_w_gu[l], ffn_w_down[l], ln2_g[l], ln2_b[l])
        ada_p = cp @ w_ada[l] + b_ada[l]
        ada_s = cs @ w_ada[l] + b_ada[l]
        xp, *sp = _layer(xp, ada_p, pos_p, zero_gla, zero_h, zero_conv, None, None, lw)
        past_ckv = cache_ckv[l][page_table].reshape(bs, n_pages * PAGE_SIZE, MLA_KV_LORA)
        past_kr = cache_krope[l][page_table].reshape(bs, n_pages * PAGE_SIZE, MLA_ROPE)
        xs, *ss = _layer(xs, ada_s, pos_s, state_gla[l], state_lru[l], state_conv[l], past_ckv, past_kr, lw)
        st_p.append(sp)
        st_s.append(ss)

    def stk(outs, j):
        return jnp.stack([o[j] for o in outs])

    return (xp, xs, stk(st_p, 0), stk(st_s, 0), stk(st_p, 1), stk(st_s, 1), stk(st_p, 2), stk(st_s, 2),
            stk(st_p, 3), stk(st_s, 3), stk(st_p, 4), stk(st_s, 4))
```

```cpp
#include <hip/hip_runtime.h>
#include <cstdio>
#include <cstdint>
#include <cmath>

#define GAS __attribute__((address_space(1)))
#define LAS __attribute__((address_space(3)))
typedef unsigned short bf16;
typedef short bf16x8 __attribute__((ext_vector_type(8)));
typedef short s16x4 __attribute__((ext_vector_type(4)));
typedef short v4i16_t __attribute__((ext_vector_type(4)));
typedef float f32x4 __attribute__((ext_vector_type(4)));
typedef float f32x2 __attribute__((ext_vector_type(2)));
typedef unsigned u32x4 __attribute__((ext_vector_type(4)));
typedef unsigned u32x2 __attribute__((ext_vector_type(2)));
typedef __bf16 bf16x2_t __attribute__((ext_vector_type(2)));

constexpr int DM = 1024, NBP = 8, SEQ = 2048, DEPTH = 4, NBS = 32, TS = 8, PAST = 16384, PAGE = 128, NPAGES = 128;
constexpr int MP = NBP * SEQ, MS = NBS * TS, MT = MP + MS;
constexpr int NBI = NBP + NBS;
constexpr int NPROJ = 1792, INCOLS = 1712, DFF = 2816;
constexpr int NPHYS = 5120;
constexpr int PC_GQ = 0, PC_GK = 128, PC_GV = 256, PC_GG = 512, PC_LX = 768, PC_LG = 1024, PC_DQ = 1280, PC_DKV = 1536, PC_KR = 1664, PC_GLR = 1696;
constexpr float LN_EPS = 1e-5f, RMS_EPS = 1e-6f;
constexpr float DN_ALPHA = 1.681792830507429f;
constexpr float QSCALE = 0.10206207261596577f * 1.4426950408889634f;
constexpr float GLA_SCALE = 0.17677669529663687f;

constexpr size_t O_YP = 0, O_YS = O_YP + (size_t)MP * DM, O_GLAP = O_YS + (size_t)MS * DM, O_GLAS = O_GLAP + 4 * 8 * 8192, O_LRUP = O_GLAS + 4 * 32 * 8192,
                 O_LRUS = O_LRUP + 4 * 8 * 256, O_CONVP = O_LRUS + 4 * 32 * 256, O_CONVS = O_CONVP + 4 * 8 * 768, O_CKVP = O_CONVS + 4 * 32 * 768,
                 O_CKVS = O_CKVP + (size_t)4 * 8 * 2048 * 128, O_KRP = O_CKVS + 4 * 32 * 8 * 128, O_KRS = O_KRP + (size_t)4 * 8 * 2048 * 32, O_END = O_KRS + 4 * 32 * 8 * 32;

constexpr size_t MiB = 1u << 20;
constexpr size_t WS_CTL = 0, CTL_ZERO_BYTES = 1 * MiB;
constexpr size_t WS_ADA = 1 * MiB, WS_SC = 5 * MiB, WS_RCOS = 5 * MiB + 512 * 1024, WS_RSIN = 5 * MiB + 768 * 1024, WS_SSQ = 6 * MiB;
constexpr size_t WS_WIN = 8 * MiB, WS_WQ = 22 * MiB, WS_WKV = 24 * MiB, WS_WOUT = 26 * MiB, WS_WGU = 34 * MiB, WS_WDN = 78 * MiB;
constexpr size_t WS_X = 100 * MiB, WS_H = 166 * MiB, WS_PROJ = 199 * MiB, WS_QB = 256 * MiB, WS_KB = 281 * MiB, WS_VB = 305 * MiB, WS_MIX = 321 * MiB, WS_F = 354 * MiB;
constexpr size_t WS_GL = 444 * MiB, WS_GLS = 460 * MiB, WS_GD = 461 * MiB, WS_GDS = 461 * MiB + 512 * 1024, WS_BCUM = 462 * MiB, WS_HLOC = 471 * MiB, WS_ACUM = 488 * MiB;
constexpr size_t WS_AAGG = 505 * MiB, WS_HAGG = 506 * MiB, WS_HIN = 507 * MiB, WS_QLAT = 508 * MiB, WS_PO = 509 * MiB, WS_PML = 525 * MiB, WS_END = 526 * MiB;
constexpr int CW_BAR = 4096;

__device__ __forceinline__ float bf2f(bf16 v) { return __uint_as_float((unsigned)v << 16); }
__device__ __forceinline__ unsigned pk2(float lo, float hi) { f32x2 v = {lo, hi}; bf16x2_t b = __builtin_convertvector(v, bf16x2_t); return __builtin_bit_cast(unsigned, b); }
__device__ __forceinline__ bf16 f2bf(float f) { return (bf16)(pk2(f, 0.f) & 0xffffu); }
__device__ __forceinline__ int row_bi(int r) { return r < MP ? (r >> 11) : NBP + ((r - MP) >> 3); }
__device__ __forceinline__ int row_tix(int r) { return r < MP ? (r & 2047) : 2048 + ((r - MP) & 7); }
__device__ __forceinline__ float wave_sum(float v) {
#pragma unroll
    for (int o = 1; o < 64; o <<= 1) v += __shfl_xor(v, o);
    return v;
}
__device__ __forceinline__ float sigmoidf_(float x) { return 1.f / (1.f + __expf(-x)); }
__device__ __forceinline__ float siluf_(float x) { return x / (1.f + __expf(-x)); }
__device__ __forceinline__ float gelu_tanh(float x) { const float u = 0.7978845608028654f * (x + 0.044715f * x * x * x); return 0.5f * x * (1.f + tanhf(u)); }
__device__ __forceinline__ float log_sigmoidf_(float x) { return -(fmaxf(-x, 0.f) + log1pf(__expf(-fabsf(x)))); }
#define LDS_WAIT() asm volatile("s_waitcnt lgkmcnt(0)" ::: "memory")

namespace pg8 {
typedef unsigned short bf16_t;
constexpr int BM = 256, BK = 64, HALF = 128, HTB = HALF * BK * 2, STAGE_BYTES = 8 * HTB, NXCD = 8, WGM = 8;
__host__ __device__ __forceinline__ int lds_byte(int r, int c) { const int st = (r >> 4) * 2 + (c >> 5), rr = r & 15, cc = c & 31, ob = rr * 64 + cc * 2; return st * 1024 + (ob ^ (((ob >> 9) & 1) << 5)); }
__host__ __device__ __forceinline__ void stage_rc(int b, int& R, int& C) { const int st = b / 1024, sb = b % 1024, swz = sb ^ (((sb >> 9) & 1) << 5); R = (st >> 1) * 16 + swz / 64; C = (st & 1) * 32 + (swz % 64) / 2; }
__host__ __device__ __forceinline__ int perm32(int rho) { const int n = rho >> 4, i = rho & 15; return 8 * (i >> 2) + 4 * n + (i & 3); }
struct Unit { int pm, pn; };
struct Gemm { const bf16_t* A; const bf16_t* Bt; int M, N, K, lda, ldb; };
struct StaticOrder {
    int nM, nN, nwg, G, c;
    __device__ void init(int M, int N, int G_, int c_) { nM = M / BM; nN = N / BM; nwg = nM * nN; G = G_; c = c_; }
    __device__ bool next(int i, Unit& u) const {
        const long L = (long)i * G + c; if (L >= nwg) return false;
        int wgid = (int)L; { const int q = nwg / NXCD, r = nwg % NXCD, xcd = wgid % NXCD, off = wgid / NXCD; wgid = (xcd < r ? xcd * (q + 1) : r * (q + 1) + (xcd - r) * q) + off; }
        const int nig = WGM * nN, gid = wgid / nig, fm = gid * WGM, gsz = (nM - fm) < WGM ? (nM - fm) : WGM;
        u.pm = fm + ((wgid % nig) % gsz); u.pn = (wgid % nig) / gsz; return true;
    }
};
template <class Epi, bool ALIGN_EPI>
__device__ __forceinline__ void gemm_phase(LAS unsigned char* lds, const Gemm g, const StaticOrder& S, const Epi& E, const int tid) {
    const int wid = __builtin_amdgcn_readfirstlane(tid >> 6), lane = tid & 63, wr = wid >> 2, wc = wid & 3, fr = lane & 15, fq = lane >> 4;
    const int nt = g.K / BK;
    unsigned voffA[2], voffB[2];
#pragma unroll
    for (int i = 0; i < 2; ++i) { int R, C; stage_rc(tid * 16 + i * 8192, R, C); const int Rb = Epi::PERM ? ((R & ~31) + perm32(R & 31)) : R;
        voffA[i] = (unsigned)(R * g.lda + C) * 2u; voffB[i] = (unsigned)(Rb * g.ldb + C) * 2u; }
    const size_t kstep = (size_t)(BK * 2);
    const size_t hstepA = (size_t)HALF * g.lda * 2, hstepB = (size_t)HALF * g.ldb * 2;
    const size_t tstepA = 2 * hstepA, tstepB = 2 * hstepB;
    const unsigned ldsw = (unsigned)wid * 1024u;
    const int aoff = lds_byte(wr * 64 + fr, fq * 8), boff = lds_byte(wc * 32 + fr, fq * 8);
#define PG8_SA(b, h) (((b) * 2 + (h)) * HTB)
#define PG8_SB(b, h) ((4 + (b) * 2 + (h)) * HTB)
#define PG8_STAGE(bufoff, gbase, voff) do { _Pragma("unroll") for (int _i = 0; _i < 2; ++_i) \
        __builtin_amdgcn_global_load_lds((const unsigned*)((const char*)(gbase) + (voff)[_i]), (LAS unsigned*)(lds + (bufoff) + ldsw + _i * 8192), 16, 0, 0); } while (0)
#define PG8_LDA(dst, b, h) do { _Pragma("unroll") for (int m = 0; m < 4; ++m) _Pragma("unroll") for (int k = 0; k < 2; ++k) dst[m][k] = *(const LAS bf16x8*)(lds + PG8_SA(b, h) + aoff + m * 2048 + k * 1024); } while (0)
#define PG8_LDB(dst, b, h) do { _Pragma("unroll") for (int n = 0; n < 2; ++n) _Pragma("unroll") for (int k = 0; k < 2; ++k) dst[n][k] = *(const LAS bf16x8*)(lds + PG8_SB(b, h) + boff + n * 2048 + k * 1024); } while (0)
#define PG8_MMA(ai, bj, At, Bt) do { __builtin_amdgcn_s_setprio(1); _Pragma("unroll") for (int m = 0; m < 4; ++m) _Pragma("unroll") for (int n = 0; n < 2; ++n) _Pragma("unroll") for (int k = 0; k < 2; ++k) \
        acc[ai][bj][m][n] = __builtin_amdgcn_mfma_f32_16x16x32_bf16(Bt[n][k], At[m][k], acc[ai][bj][m][n], 0, 0, 0); __builtin_amdgcn_s_setprio(0); } while (0)
#define PG8_WAIT_V(n) asm volatile("s_waitcnt vmcnt(" #n ")" ::: "memory")
#define PG8_WAIT_L(n) asm volatile("s_waitcnt lgkmcnt(" #n ")" ::: "memory")
#define PG8_BAR __builtin_amdgcn_s_barrier()
#define PG8_SCHED __builtin_amdgcn_sched_barrier(0)
    Unit cur, nxt; int ui = 0;
    if (!S.next(0, cur)) return;
    f32x4 acc[2][2][4][2];
#pragma unroll
    for (int a = 0; a < 2; ++a)
#pragma unroll
        for (int b = 0; b < 2; ++b)
#pragma unroll
            for (int m = 0; m < 4; ++m)
#pragma unroll
                for (int n = 0; n < 2; ++n) acc[a][b][m][n] = (f32x4){0.f, 0.f, 0.f, 0.f};
    bf16x8 At[4][2], B0[2][2], B1[2][2];
    const char* cA = (const char*)g.A + (size_t)cur.pm * tstepA; const char* cB = (const char*)g.Bt + (size_t)cur.pn * tstepB;
    PG8_STAGE(PG8_SB(0, 0), cB, voffB); PG8_STAGE(PG8_SB(0, 1), cB + hstepB, voffB); PG8_STAGE(PG8_SA(0, 0), cA, voffA); PG8_STAGE(PG8_SA(0, 1), cA + hstepA, voffA);
    if (wr == 1) PG8_BAR;
    PG8_WAIT_V(2); PG8_BAR;
    PG8_STAGE(PG8_SB(1, 0), cB + kstep, voffB); PG8_STAGE(PG8_SA(1, 0), cA + kstep, voffA); PG8_STAGE(PG8_SB(1, 1), cB + hstepB + kstep, voffB);
    PG8_WAIT_V(6); PG8_BAR;
    for (;;) {
        const bool has_next = S.next(ui + 1, nxt);
        const char* nA = has_next ? (const char*)g.A + (size_t)nxt.pm * tstepA : cA; const char* nB = has_next ? (const char*)g.Bt + (size_t)nxt.pn * tstepB : cB;
#pragma unroll 1
        for (int t = 0; t < nt; t += 2) {
            const bool last = (t == nt - 2);
            const char* a1 = cA + (size_t)(t + 1) * kstep;
            const char* a2 = last ? nA : cA + (size_t)(t + 2) * kstep; const char* b2 = last ? nB : cB + (size_t)(t + 2) * kstep;
            const char* a3 = a2 + kstep; const char* b3 = b2 + kstep;
            PG8_LDB(B0, 0, 0); PG8_LDB(B1, 0, 1); PG8_SCHED; PG8_LDA(At, 0, 0); PG8_STAGE(PG8_SA(1, 1), a1 + hstepA, voffA);
            PG8_WAIT_V(8); PG8_WAIT_L(0); PG8_BAR; PG8_MMA(0, 0, At, B0); PG8_MMA(0, 1, At, B1); PG8_BAR; PG8_SCHED;
            PG8_LDA(At, 0, 1); PG8_STAGE(PG8_SB(0, 0), b2, voffB); PG8_STAGE(PG8_SB(0, 1), b2 + hstepB, voffB); PG8_STAGE(PG8_SA(0, 0), a2, voffA);
            PG8_WAIT_V(8); PG8_WAIT_L(0); PG8_BAR; PG8_MMA(1, 0, At, B0); PG8_MMA(1, 1, At, B1); PG8_BAR; PG8_SCHED;
            PG8_LDB(B0, 1, 0); PG8_LDB(B1, 1, 1); PG8_SCHED; PG8_LDA(At, 1, 0); PG8_STAGE(PG8_SA(0, 1), a2 + hstepA, voffA);
            PG8_WAIT_V(8); PG8_WAIT_L(0); PG8_BAR; PG8_MMA(0, 0, At, B0); PG8_MMA(0, 1, At, B1); PG8_BAR; PG8_SCHED;
            PG8_LDA(At, 1, 1); PG8_STAGE(PG8_SB(1, 0), b3, voffB); PG8_STAGE(PG8_SB(1, 1), b3 + hstepB, voffB); PG8_STAGE(PG8_SA(1, 0), a3, voffA);
            PG8_WAIT_V(8); PG8_WAIT_L(0); PG8_BAR; PG8_MMA(1, 0, At, B0); PG8_MMA(1, 1, At, B1); PG8_BAR; PG8_SCHED;
        }
        if constexpr (ALIGN_EPI) { if (wr == 0) PG8_BAR; }
        E(acc, cur, wr, wc, fr, fq);
        if (!has_next) break;
#pragma unroll
        for (int a = 0; a < 2; ++a)
#pragma unroll
            for (int b = 0; b < 2; ++b)
#pragma unroll
                for (int m = 0; m < 4; ++m)
#pragma unroll
                    for (int n = 0; n < 2; ++n) acc[a][b][m][n] = (f32x4){0.f, 0.f, 0.f, 0.f};
        cur = nxt; cA = nA; cB = nB; ++ui;
        if constexpr (ALIGN_EPI) { if (wr == 1) PG8_BAR; }
    }
    PG8_WAIT_V(0);
    if constexpr (!ALIGN_EPI) { if (wr == 0) PG8_BAR; }
    PG8_BAR;
#undef PG8_SA
#undef PG8_SB
#undef PG8_STAGE
#undef PG8_LDA
#undef PG8_LDB
#undef PG8_MMA
#undef PG8_WAIT_V
#undef PG8_WAIT_L
#undef PG8_BAR
#undef PG8_SCHED
}

typedef const f32x4 (&AccT)[2][2][4][2];
__device__ __forceinline__ u32x4 pack8(f32x4 v0, f32x4 v1) { u32x4 w; w.x = pk2(v0[0], v0[1]); w.y = pk2(v0[2], v0[3]); w.z = pk2(v1[0], v1[1]); w.w = pk2(v1[2], v1[3]); return w; }
struct EpiProj { static constexpr bool PERM = true;
    bf16* O; float* ssq;
    __device__ __forceinline__ void operator()(AccT acc, const Unit& u, int wr, int wc, int fr, int fq) const {
        const int row0 = u.pm * BM + wr * 64 + fr, col0 = u.pn * BM + wc * 32 + 8 * fq;
        const bool isq = (u.pn == 5), iskv = (u.pn == 6);
#pragma unroll
        for (int ai = 0; ai < 2; ++ai)
#pragma unroll
            for (int m = 0; m < 4; ++m) { const int row = row0 + ai * HALF + m * 16; bf16* rowp = O + (size_t)row * NPROJ + col0;
#pragma unroll
                for (int bj = 0; bj < 2; ++bj) *(u32x4*)(rowp + bj * HALF) = pack8(acc[ai][bj][m][0], acc[ai][bj][m][1]);
                if (isq || iskv) {
                    float q = 0.f;
#pragma unroll
                    for (int bj = 0; bj < 2; ++bj) { if (bj == 1 && iskv) continue;
#pragma unroll
                        for (int n = 0; n < 2; ++n) { const f32x4 x = acc[ai][bj][m][n]; q += (x[0] * x[0] + x[1] * x[1]) + (x[2] * x[2] + x[3] * x[3]); } }
                    q += __shfl_xor(q, 16); q += __shfl_xor(q, 32);
                    if (fq == 0) ssq[(size_t)row * 8 + (iskv ? 4 : 0) + wc] = q;
                } }
    }
};
struct EpiQ { static constexpr bool PERM = true;
    bf16* Q; const float* ssq; const float* rcos; const float* rsin;
    __device__ __forceinline__ void operator()(AccT acc, const Unit& u, int wr, int wc, int fr, int fq) const {
        const int row0 = u.pm * BM + wr * 64 + fr, col0 = u.pn * BM + wc * 32 + 8 * fq;
#pragma unroll
        for (int ai = 0; ai < 2; ++ai)
#pragma unroll
            for (int m = 0; m < 4; ++m) { const int row = row0 + ai * HALF + m * 16; const f32x4 sp = *(const f32x4*)(ssq + (size_t)row * 8);
                const float rinv = rsqrtf(((sp[0] + sp[1]) + (sp[2] + sp[3])) * (1.f / 256.f) + RMS_EPS) * QSCALE; const int tix = row_tix(row);
#pragma unroll
                for (int bj = 0; bj < 2; ++bj) { const int G = u.pn * 8 + bj * 4 + wc; f32x4 v0 = acc[ai][bj][m][0] * rinv, v1 = acc[ai][bj][m][1] * rinv;
                    if ((G % 3) == 2) { const f32x4 c4 = *(const f32x4*)(rcos + tix * 16 + 4 * fq), s4 = *(const f32x4*)(rsin + tix * 16 + 4 * fq);
                        f32x4 o0, o1;
                        o0[0] = v0[0] * c4[0] - v0[1] * s4[0]; o0[1] = v0[1] * c4[0] + v0[0] * s4[0]; o0[2] = v0[2] * c4[1] - v0[3] * s4[1]; o0[3] = v0[3] * c4[1] + v0[2] * s4[1];
                        o1[0] = v1[0] * c4[2] - v1[1] * s4[2]; o1[1] = v1[1] * c4[2] + v1[0] * s4[2]; o1[2] = v1[2] * c4[3] - v1[3] * s4[3]; o1[3] = v1[3] * c4[3] + v1[2] * s4[3];
                        v0 = o0; v1 = o1; }
                    *(u32x4*)(Q + (size_t)row * 768 + col0 + bj * HALF) = pack8(v0, v1); } }
    }
};
struct EpiKV { static constexpr bool PERM = true;
    bf16* Kb; bf16* Vb; const float* ssq;
    __device__ __forceinline__ void operator()(AccT acc, const Unit& u, int wr, int wc, int fr, int fq) const {
        const int row0 = u.pm * BM + wr * 64 + fr, col0 = u.pn * BM + wc * 32 + 8 * fq;
#pragma unroll
        for (int ai = 0; ai < 2; ++ai)
#pragma unroll
            for (int m = 0; m < 4; ++m) { const int row = row0 + ai * HALF + m * 16; const f32x4 sp = *(const f32x4*)(ssq + (size_t)row * 8 + 4);
                const float rinv = rsqrtf(((sp[0] + sp[1]) + (sp[2] + sp[3])) * (1.f / 128.f) + RMS_EPS);
#pragma unroll
                for (int bj = 0; bj < 2; ++bj) { const int c = col0 + bj * HALF;
                    bf16* dst = (c < 512) ? Kb + (size_t)row * 768 + (c >> 6) * 96 + (c & 63) : Vb + (size_t)row * 512 + (c - 512);
                    *(u32x4*)dst = pack8(acc[ai][bj][m][0] * rinv, acc[ai][bj][m][1] * rinv); } }
    }
};
struct EpiRes { static constexpr bool PERM = false;
    float* X; const float* gate;
    __device__ __forceinline__ void operator()(AccT acc, const Unit& u, int wr, int wc, int fr, int fq) const {
        const int row0 = u.pm * BM + wr * 64 + fr, col0 = u.pn * BM + wc * 32 + 4 * fq;
#pragma unroll
        for (int ai = 0; ai < 2; ++ai)
#pragma unroll
            for (int m = 0; m < 4; ++m) { const int row = row0 + ai * HALF + m * 16; const float* gp = gate + (size_t)row_bi(row) * 6144 + col0; float* xp = X + (size_t)row * DM + col0;
#pragma unroll
                for (int bj = 0; bj < 2; ++bj)
#pragma unroll
                    for (int n = 0; n < 2; ++n) { const int o = bj * HALF + n * 16; const f32x4 g4 = *(const f32x4*)(gp + o); f32x4 x4 = *(const f32x4*)(xp + o);
                        x4 = x4 * DN_ALPHA + g4 * acc[ai][bj][m][n]; *(f32x4*)(xp + o) = x4; } }
    }
};
struct EpiSwi { static constexpr bool PERM = true;
    bf16* F;
    __device__ __forceinline__ void operator()(AccT acc, const Unit& u, int wr, int wc, int fr, int fq) const {
        const int row0 = u.pm * BM + wr * 64 + fr, col0 = u.pn * HALF + wc * 32 + 8 * fq;
#pragma unroll
        for (int ai = 0; ai < 2; ++ai)
#pragma unroll
            for (int m = 0; m < 4; ++m) { const int row = row0 + ai * HALF + m * 16; f32x4 o[2];
#pragma unroll
                for (int n = 0; n < 2; ++n) { const f32x4 gg = acc[ai][0][m][n], uu = acc[ai][1][m][n];
#pragma unroll
                    for (int j = 0; j < 4; ++j) o[n][j] = siluf_(gg[j]) * uu[j]; }
                *(u32x4*)(F + (size_t)row * DFF + col0) = pack8(o[0], o[1]); }
    }
};
}

#define XB_TMO      128
#define XB_XCNT(j)  (256  + 64 * (j))
#define XB_XSUB(j)  (1280 + 64 * (j))
#define XB_XGEN(j)  (2304 + 64 * (j))
#define XB_TOP      3328
#define XB_TOPGEN   3392
#define XCD_BAR_WORDS 3456
#define XB_SPIN_CAP (1u << 18)
__device__ __forceinline__ unsigned xb_ld(unsigned* p)              { return __hip_atomic_load(p, __ATOMIC_RELAXED, __HIP_MEMORY_SCOPE_AGENT); }
__device__ __forceinline__ unsigned xb_add(unsigned* p, unsigned v) { return __hip_atomic_fetch_add(p, v, __ATOMIC_RELAXED, __HIP_MEMORY_SCOPE_AGENT); }
__device__ __forceinline__ unsigned xb_xcc_id() { return (unsigned)__builtin_amdgcn_s_getreg((3 << 11) | 20) & 0xFu; }
#define XB_SPIN(cond, bar) do { unsigned _sp = 0; while (cond) { __builtin_amdgcn_s_sleep(1); \
    if ((++_sp & 255u) == 0u) { if (xb_ld(&(bar)[XB_TMO])) break; if (_sp > XB_SPIN_CAP) { atomicAdd(&(bar)[XB_TMO], 1u); break; } } } } while (0)
struct XcdBarrier { unsigned* bar; unsigned x; volatile LAS unsigned* st; };
__device__ __forceinline__ XcdBarrier xcd_barrier_post(unsigned* bar, volatile LAS unsigned* st) {
    XcdBarrier b; b.bar = bar; b.x = xb_xcc_id(); b.st = st;
    if (threadIdx.x == 0) (void)xb_add(&bar[XB_XCNT(b.x)], 1u);
    return b;
}
__device__ __forceinline__ void xcd_barrier_complete(unsigned* bar, unsigned x, unsigned& nloc, unsigned& nx) {
    const unsigned G = gridDim.x * gridDim.y * gridDim.z;
    unsigned sum, cnt, mine, sp = 0u;
    for (;;) {
        sum = 0u; cnt = 0u; mine = 0u;
#pragma unroll
        for (unsigned j = 0; j < 16; ++j) { const unsigned c = xb_ld(&bar[XB_XCNT(j)]); sum += c; cnt += (c > 0u) ? 1u : 0u; mine = (j == x) ? c : mine; }
        if (sum == G) break;
        __builtin_amdgcn_s_sleep(1);
        if ((++sp & 255u) == 0u) { if (xb_ld(&bar[XB_TMO])) break; if (sp > XB_SPIN_CAP) { atomicAdd(&bar[XB_TMO], 1u); break; } }
    }
    nloc = mine > 0u ? mine : 1u; nx = cnt > 0u ? cnt : 1u;
}
__device__ __forceinline__ void xcd_barrier(const XcdBarrier& b) {
    asm volatile("s_waitcnt vmcnt(0)" ::: "memory");
    __syncthreads();
    if (threadIdx.x == 0) {
        unsigned* bar = b.bar;
        __builtin_amdgcn_s_waitcnt(0);
        unsigned nloc = b.st[0], nx = b.st[1];
        if (nloc == 0u) { xcd_barrier_complete(bar, b.x, nloc, nx); b.st[0] = nloc; b.st[1] = nx; }
        const unsigned old = xb_add(&bar[XB_XSUB(b.x)], 1u);
        const unsigned gen = old / nloc;
        if (old + 1u == (gen + 1u) * nloc) {
            __builtin_amdgcn_fence(__ATOMIC_RELEASE, "agent");
            asm volatile("s_waitcnt vmcnt(0)" ::: "memory");
            const unsigned og = xb_add(&bar[XB_TOP], 1u);
            const unsigned tg = og / nx;
            if (og + 1u == (tg + 1u) * nx) xb_add(&bar[XB_TOPGEN], 1u);
            else XB_SPIN(xb_ld(&bar[XB_TOPGEN]) == tg, bar);
            __builtin_amdgcn_fence(__ATOMIC_ACQUIRE, "agent");
            xb_add(&bar[XB_XGEN(b.x)], 1u);
            asm volatile("s_waitcnt vmcnt(0)" ::: "memory");
        } else {
            XB_SPIN(xb_ld(&bar[XB_XGEN(b.x)]) == gen, bar);
            __builtin_amdgcn_fence(__ATOMIC_ACQUIRE, "agent");
            asm volatile("s_waitcnt vmcnt(0)" ::: "memory");
        }
    }
    __syncthreads();
}

struct Args { const float* in[37]; const int* page_table; float* out; unsigned char* ws; int ph_lo, ph_hi; };
enum { I_XP = 0, I_XS, I_CP, I_CS, I_SGLA, I_SLRU, I_SCONV, I_CCKV, I_CKR, I_PT, I_LNIG, I_LNIB, I_WADA, I_BADA, I_WIN, I_GWG, I_GBG, I_GNG, I_CW, I_CB, I_LWA, I_LBA, I_LWX, I_LBX,
       I_LAM, I_QNG, I_WUQ, I_KVNG, I_WUK, I_WUV, I_WOUT, I_LN1G, I_LN1B, I_WGU, I_WDN, I_LN2G, I_LN2B };
constexpr int RING_BYTES = 131072, MISC_OFF = RING_BYTES + 320, LDS_BYTES = 147456;
constexpr int NTHR = 512, NWAVES = 8;

enum { CV_PLAIN = 0, CV_IN, CV_Q, CV_GU };
template <int KIND> __device__ __forceinline__ int cv_scol(int n) {
    if (KIND == CV_IN) {
        if (n < 768) return n; if (n < 1024) return n - 768 + 784; if (n < 1280) return n - 1024 + 1040; if (n < 1536) return n - 1280 + 1296;
        if (n < 1664) return n - 1536 + 1552; if (n < 1696) return n - 1664 + 1680; if (n < 1712) return n - 1696 + 768; return -1;
    } else if (KIND == CV_Q) { const int h = n / 96, p = n % 96; const int d = p < 64 ? p : 64 + ((p - 64) >> 1) + 16 * ((p - 64) & 1); return h * 96 + d;
    } else if (KIND == CV_GU) { return ((n & 255) >> 7) * DFF + (n >> 8) * 128 + (n & 127);
    } else return n;
}
template <int KIND> __device__ __forceinline__ void cv_item(const float* W, int ldw, bf16* WT, int Kd, int row_off, const float* rscale, LAS float* scr, int kb, int nb, int lane) {
    const int k0 = 64 * kb, n0 = 32 * nb; const int sc = cv_scol<KIND>(n0 + (lane & 31));
#pragma unroll 8
    for (int i = 0; i < 32; ++i) { const int kk = 2 * i + (lane >> 5); float v = sc >= 0 ? W[(size_t)(k0 + kk) * ldw + sc] : 0.f; if (rscale) v *= rscale[k0 + kk]; scr[kk * 33 + (lane & 31)] = v; }
    LDS_WAIT(); asm volatile("" ::: "memory");
    const int c = lane & 7;
#pragma unroll
    for (int j = 0; j < 4; ++j) { const int n = (lane >> 3) + 8 * j; const LAS float* s = scr + (8 * c) * 33 + n;
        u32x4 o; o.x = pk2(s[0 * 33], s[1 * 33]); o.y = pk2(s[2 * 33], s[3 * 33]); o.z = pk2(s[4 * 33], s[5 * 33]); o.w = pk2(s[6 * 33], s[7 * 33]);
        *(u32x4*)(WT + (size_t)(row_off + n0 + n) * Kd + k0 + 8 * c) = o; }
    LDS_WAIT(); asm volatile("" ::: "memory");
}

__device__ __forceinline__ void ln_row(const float* src, const float* g, const float* b, float* xout, bf16* hout, const float* scale, const float* shift, int lane) {
    const f32x4* xr = (const f32x4*)src + lane;
    f32x4 v[4]; float s = 0.f;
#pragma unroll
    for (int j = 0; j < 4; ++j) { v[j] = xr[64 * j]; s += (v[j][0] + v[j][1]) + (v[j][2] + v[j][3]); }
    const float mean = wave_sum(s) * (1.f / DM); float s2 = 0.f;
#pragma unroll
    for (int j = 0; j < 4; ++j) { v[j] = v[j] - mean; s2 += (v[j][0] * v[j][0] + v[j][1] * v[j][1]) + (v[j][2] * v[j][2] + v[j][3] * v[j][3]); }
    const float rstd = rsqrtf(wave_sum(s2) * (1.f / DM) + LN_EPS);
#pragma unroll
    for (int j = 0; j < 4; ++j) { const int c = lane + 64 * j; const f32x4 y = v[j] * rstd * ((const f32x4*)g)[c] + ((const f32x4*)b)[c];
        if (xout) ((f32x4*)xout)[c] = y;
        if (hout) { const f32x4 hh = y * (((const f32x4*)scale)[c] + 1.f) + ((const f32x4*)shift)[c]; u32x2 w; w.x = pk2(hh[0], hh[1]); w.y = pk2(hh[2], hh[3]); ((u32x2*)hout)[c] = w; } }
}

__device__ __forceinline__ f32x4 mfma16(bf16x8 a, bf16x8 b, f32x4 c) { return __builtin_amdgcn_mfma_f32_16x16x32_bf16(a, b, c, 0, 0, 0); }
__device__ __forceinline__ s16x4 vtr(const LAS unsigned char* p) { return __builtin_bit_cast(s16x4, __builtin_amdgcn_ds_read_tr16_b64_v4i16((LAS v4i16_t*)p)); }

__global__ void __launch_bounds__(NTHR, 2) fwd(Args args) {
    extern __shared__ __attribute__((aligned(16))) unsigned char lds_raw[];
    LAS unsigned char* lds = (LAS unsigned char*)lds_raw;
    volatile LAS unsigned* MISC = (volatile LAS unsigned*)(lds + MISC_OFF);
    const int wid0 = __builtin_amdgcn_readfirstlane((int)threadIdx.x >> 6);
    const int G = gridDim.x, blk = blockIdx.x;
    unsigned char* ws = args.ws;
    for (int u = threadIdx.x; u < (LDS_BYTES - RING_BYTES) / 4; u += NTHR) ((LAS unsigned*)(lds + RING_BYTES))[u] = 0u;
    __syncthreads();
    const bool use_bar = (args.ph_hi - args.ph_lo) > 1;
    XcdBarrier bar; bar.bar = (unsigned*)(ws + WS_CTL) + CW_BAR; bar.x = 0; bar.st = nullptr;
    if (use_bar) bar = xcd_barrier_post((unsigned*)(ws + WS_CTL) + CW_BAR, MISC + 8);

    float* ADA = (float*)(ws + WS_ADA); float* SC = (float*)(ws + WS_SC); float* RCOS = (float*)(ws + WS_RCOS); float* RSIN = (float*)(ws + WS_RSIN); float* SSQ = (float*)(ws + WS_SSQ);
    bf16* WIN = (bf16*)(ws + WS_WIN); bf16* WQ = (bf16*)(ws + WS_WQ); bf16* WKV = (bf16*)(ws + WS_WKV); bf16* WOUT = (bf16*)(ws + WS_WOUT); bf16* WGU = (bf16*)(ws + WS_WGU); bf16* WDN = (bf16*)(ws + WS_WDN);
    float* X = (float*)(ws + WS_X); bf16* H = (bf16*)(ws + WS_H); bf16* PROJ = (bf16*)(ws + WS_PROJ); bf16* QB = (bf16*)(ws + WS_QB); bf16* KB = (bf16*)(ws + WS_KB); bf16* VB = (bf16*)(ws + WS_VB);
    bf16* MIX = (bf16*)(ws + WS_MIX); bf16* FB = (bf16*)(ws + WS_F);
    float* GL = (float*)(ws + WS_GL); float* GLS = (float*)(ws + WS_GLS); float* GD = (float*)(ws + WS_GD); float* GDS = (float*)(ws + WS_GDS); float* BCUM = (float*)(ws + WS_BCUM);
    float* HLOC = (float*)(ws + WS_HLOC); float* ACUM = (float*)(ws + WS_ACUM); float* AAGG = (float*)(ws + WS_AAGG); float* HAGG = (float*)(ws + WS_HAGG); float* HIN = (float*)(ws + WS_HIN);
    bf16* QLAT = (bf16*)(ws + WS_QLAT); float* PO = (float*)(ws + WS_PO); float* PML = (float*)(ws + WS_PML);
    float* out = args.out;

    int phase = 0;
#define FRESH_TID int lane; asm volatile("v_mbcnt_lo_u32_b32 %0, -1, 0\n\tv_mbcnt_hi_u32_b32 %0, -1, %0" : "=v"(lane)); const int wid = wid0; const int tid = wid * 64 + lane; (void)tid;
#define PHASE_BEGIN if (phase >= args.ph_lo && phase < args.ph_hi) { FRESH_TID
#define PHASE_END   if (use_bar && phase + 1 < args.ph_hi) xcd_barrier(bar); } ++phase;

    PHASE_BEGIN
    {
        LAS float* scr = (LAS float*)(lds + wid * 16384);
        const int gw = blk * NWAVES + wid, NGW = G * NWAVES;
        constexpr int I_IN = 16 * 56, I_Q = 4 * 24, I_KV = 2 * 32, I_O = 16 * 32, I_GU = 16 * 176, I_DN = 44 * 32, I_L = I_IN + I_Q + I_KV + I_O + I_GU + I_DN;
        for (int it = gw; it < DEPTH * I_L; it += NGW) {
            const int l = it / I_L; int r = it % I_L;
            if (r < I_IN) { cv_item<CV_IN>(args.in[I_WIN] + (size_t)l * DM * INCOLS, INCOLS, WIN + (size_t)l * NPROJ * DM, DM, 0, nullptr, scr, r / 56, r % 56, lane); continue; } r -= I_IN;
            if (r < I_Q) { cv_item<CV_Q>(args.in[I_WUQ] + (size_t)l * 256 * 768, 768, WQ + (size_t)l * 768 * 256, 256, 0, args.in[I_QNG] + l * 256, scr, r / 24, r % 24, lane); continue; } r -= I_Q;
            if (r < I_KV) { const int kb = r / 32, nb = r % 32;
                if (nb < 16) cv_item<CV_PLAIN>(args.in[I_WUK] + (size_t)l * 128 * 512, 512, WKV + (size_t)l * 1024 * 256, 256, 0, args.in[I_KVNG] + l * 128, scr, kb, nb, lane);
                else cv_item<CV_PLAIN>(args.in[I_WUV] + (size_t)l * 128 * 512, 512, WKV + (size_t)l * 1024 * 256, 256, 512, args.in[I_KVNG] + l * 128, scr, kb, nb - 16, lane);
                continue; } r -= I_KV;
            if (r < I_O) { cv_item<CV_PLAIN>(args.in[I_WOUT] + (size_t)l * DM * DM, DM, WOUT + (size_t)l * DM * DM, DM, 0, nullptr, scr, r / 32, r % 32, lane); continue; } r -= I_O;
            if (r < I_GU) { cv_item<CV_GU>(args.in[I_WGU] + (size_t)l * DM * 2 * DFF, 2 * DFF, WGU + (size_t)l * 2 * DFF * DM, DM, 0, nullptr, scr, r / 176, r % 176, lane); continue; } r -= I_GU;
            cv_item<CV_PLAIN>(args.in[I_WDN] + (size_t)l * DFF * DM, DM, WDN + (size_t)l * DM * DFF, DFF, 0, nullptr, scr, r / 32, r % 32, lane);
        }
        const int gt = blk * NTHR + tid, NGT = G * NTHR;
        for (int i = gt; i < DEPTH * 1024 * 16; i += NGT) { const int row = i >> 4, ch = i & 15; *(u32x4*)(WKV + (size_t)row * 256 + 128 + ch * 8) = (u32x4){0u, 0u, 0u, 0u}; }
        for (int i = gt; i < NBI * DM; i += NGT) { const int bi = i / DM, k = i % DM; const float c = bi < NBP ? args.in[I_CP][bi * DM + k] : args.in[I_CS][(bi - NBP) * DM + k]; SC[k * NBI + bi] = siluf_(c); }
        for (int i = gt; i < 2056 * 16; i += NGT) { const int tix = i >> 4, f = i & 15; const int pos = tix < 2048 ? tix : PAST + tix - 2048;
            const float invf[16] = {1.0f, 0.562341332f, 0.316227764f, 0.177827939f, 0.100000001f, 0.0562341325f, 0.0316227749f, 0.0177827943f, 0.00999999978f, 0.00562341325f, 0.00316227763f,
                                    0.00177827943f, 0.00100000005f, 0.000562341302f, 0.000316227757f, 0.00017782794f};
            float fr_ = invf[0];
#pragma unroll
            for (int q = 1; q < 16; ++q) fr_ = (f == q) ? invf[q] : fr_;
            const float ang = (float)pos * fr_; RCOS[i] = (float)cos((double)ang); RSIN[i] = (float)sin((double)ang); }
    }
    PHASE_END

    PHASE_BEGIN
    {
        LAS float* red = (LAS float*)lds;
        for (int it = blk; it < DEPTH * 96; it += G) {
            const int l = it / 96, n0 = (it % 96) * 64; const float* W = args.in[I_WADA] + (size_t)l * DM * 6144 + n0 + lane;
            float acc[NBI];
#pragma unroll
            for (int j = 0; j < NBI; ++j) acc[j] = 0.f;
            const int kbeg = wid * 128;
#pragma unroll 2
            for (int k = kbeg; k < kbeg + 128; ++k) { const float w = W[(size_t)k * 6144]; const f32x4* sc = (const f32x4*)(SC + k * NBI);
#pragma unroll
                for (int j4 = 0; j4 < NBI / 4; ++j4) { const f32x4 s = sc[j4]; acc[4 * j4] += s[0] * w; acc[4 * j4 + 1] += s[1] * w; acc[4 * j4 + 2] += s[2] * w; acc[4 * j4 + 3] += s[3] * w; } }
            __syncthreads();
#pragma unroll
            for (int j = 0; j < NBI; ++j) red[(wid * NBI + j) * 64 + lane] = acc[j];
            __syncthreads();
            for (int idx = tid; idx < NBI * 64; idx += NTHR) { const int j = idx >> 6, c = idx & 63; float s = args.in[I_BADA][l * 6144 + n0 + c];
#pragma unroll
                for (int w = 0; w < 8; ++w) s += red[(w * NBI + j) * 64 + c];
                ADA[((size_t)l * NBI + j) * 6144 + n0 + c] = s; }
        }
        __syncthreads();
    }
    PHASE_END

    PHASE_BEGIN
    {
        const int gw = blk * NWAVES + wid, NGW = G * NWAVES;
        for (int r = gw; r < MT; r += NGW) { const float* src = r < MP ? args.in[I_XP] + (size_t)r * DM : args.in[I_XS] + (size_t)(r - MP) * DM; const float* ad = ADA + (size_t)row_bi(r) * 6144;
            ln_row(src, args.in[I_LNIG], args.in[I_LNIB], X + (size_t)r * DM, H + (size_t)r * DM, ad + 1024, ad, lane); }
    }
    PHASE_END

    for (int l = 0; l < DEPTH; ++l) {
        const float* ADAl = ADA + (size_t)l * NBI * 6144;
        PHASE_BEGIN
        {
            pg8::Gemm g{H, WIN + (size_t)l * NPROJ * DM, MT, NPROJ, DM, DM, DM}; pg8::StaticOrder S; S.init(MT, NPROJ, G, blk);
            pg8::EpiProj E{PROJ, SSQ};
            pg8::gemm_phase<pg8::EpiProj, true>(lds, g, S, E, tid);
        }
        PHASE_END

        PHASE_BEGIN
        {
            { FRESH_TID pg8::Gemm g{PROJ + PC_DQ, WQ + (size_t)l * 768 * 256, MT, 768, 256, NPROJ, 256}; pg8::StaticOrder S; S.init(MT, 768, G, blk);
              pg8::EpiQ E{QB, SSQ, RCOS, RSIN}; pg8::gemm_phase<pg8::EpiQ, true>(lds, g, S, E, tid); }
            { FRESH_TID pg8::Gemm g{PROJ + PC_DKV, WKV + (size_t)l * 1024 * 256, MP, 1024, 256, NPROJ, 256}; pg8::StaticOrder S; S.init(MP, 1024, G, (blk + 128) % G);
              pg8::EpiKV E{KB, VB, SSQ}; pg8::gemm_phase<pg8::EpiKV, true>(lds, g, S, E, tid); }
            __syncthreads();
            {
            FRESH_TID
            LAS float* s_glr = (LAS float*)(lds);
            LAS float* s_bc = (LAS float*)(lds + 2048);
            LAS float* s_kd = (LAS float*)(lds + 2048 + 16384);
            LAS float* s_v = (LAS float*)(lds + 2048 + 32768);
            LAS float* s_lx = (LAS float*)(lds);
            LAS float* s_r = (LAS float*)(lds);
            LAS float* s_xc = (LAS float*)(lds + 36864);
            LAS float* s_i = (LAS float*)(lds + 36864 + 32768);
            for (int u = blk; u < 512 + NBS; u += G) {
                FRESH_TID
                const bool smp = u >= 512; const int seq = smp ? u - 512 : u >> 6, ch_ = smp ? 0 : u & 63; const int ntok = smp ? TS : 32;
                const int row0 = smp ? MP + seq * TS : seq * SEQ + ch_ * 32;
                const size_t cidx = smp ? (size_t)(512 + seq) : (size_t)u;
                for (int i = tid; i < ntok * 128; i += NTHR) { const int t = i >> 7, d = i & 127, r = row0 + t; const f32x4 sp = *(const f32x4*)(SSQ + (size_t)r * 8 + 4);
                    const float rinv = rsqrtf(((sp[0] + sp[1]) + (sp[2] + sp[3])) * (1.f / 128.f) + RMS_EPS);
                    const float v = bf2f(PROJ[(size_t)r * NPROJ + PC_DKV + d]) * rinv * args.in[I_KVNG][l * 128 + d];
                    if (smp) out[O_CKVS + (((size_t)l * NBS + seq) * TS + t) * 128 + d] = v; else out[O_CKVP + (((size_t)l * NBP + seq) * SEQ + ch_ * 32 + t) * 128 + d] = v; }
                for (int i = tid; i < ntok * 16; i += NTHR) { const int t = i >> 4, f = i & 15, r = row0 + t; const int tix = row_tix(r);
                    const float x1 = bf2f(PROJ[(size_t)r * NPROJ + PC_KR + f]), x2 = bf2f(PROJ[(size_t)r * NPROJ + PC_KR + 16 + f]); const float c = RCOS[tix * 16 + f], s = RSIN[tix * 16 + f];
                    const float o1 = x1 * c - x2 * s, o2 = x2 * c + x1 * s;
                    float* ko = smp ? out + O_KRS + (((size_t)l * NBS + seq) * TS + t) * 32 : out + O_KRP + (((size_t)l * NBP + seq) * SEQ + ch_ * 32 + t) * 32;
                    ko[f] = o1; ko[16 + f] = o2;
                    if (!smp) { const unsigned w = pk2(o1, o2);
#pragma unroll
                        for (int h = 0; h < 8; ++h) *(unsigned*)(KB + (size_t)r * 768 + h * 96 + 64 + 2 * f) = w; } }
                for (int i = tid; i < ntok * 16; i += NTHR) { const int t = i >> 4, j = i & 15; s_glr[i] = bf2f(PROJ[(size_t)(row0 + t) * NPROJ + PC_GLR + j]); }
                for (int i = tid; i < ntok * 256; i += NTHR) { const int t = i >> 8, c = i & 255; s_v[i] = bf2f(PROJ[(size_t)(row0 + t) * NPROJ + PC_GV + c]); }
                __syncthreads();
                { const int col = tid & 127, tg = tid >> 7; float wg[16];
#pragma unroll
                  for (int j = 0; j < 16; ++j) wg[j] = args.in[I_GWG][(l * 16 + j) * 128 + col];
                  const float bgc = args.in[I_GBG][l * 128 + col];
                  for (int tt = 0; tt < 8; ++tt) { const int t = tg * 8 + tt; if (t < ntok) { float x = bgc;
#pragma unroll
                      for (int j = 0; j < 16; ++j) x += s_glr[t * 16 + j] * wg[j];
                      s_bc[t * 128 + col] = log_sigmoidf_(x) * (1.f / 16.f); } } }
                __syncthreads();
                if (tid < 128) { float a = 0.f; for (int t = 0; t < ntok; ++t) { a += s_bc[t * 128 + tid]; s_bc[t * 128 + tid] = a; BCUM[(size_t)(row0 + t) * 128 + tid] = a; }
                    if (smp) GDS[seq * 128 + tid] = __expf(a); else GD[(size_t)u * 128 + tid] = __expf(a); }
                __syncthreads();
                for (int i = tid; i < ntok * 128; i += NTHR) { const int t = i >> 7, c = i & 127; const float bl = s_bc[(ntok - 1) * 128 + c];
                    s_kd[i] = bf2f(PROJ[(size_t)(row0 + t) * NPROJ + PC_GK + c]) * __expf(bl - s_bc[i]); }
                __syncthreads();
                { const int h = tid >> 7, k = (tid & 127) >> 2, vq = tid & 3; f32x4 a4[4];
#pragma unroll
                  for (int j = 0; j < 4; ++j) a4[j] = (f32x4){0.f, 0.f, 0.f, 0.f};
                  for (int t = 0; t < ntok; ++t) { const float kd = s_kd[t * 128 + h * 32 + k]; const LAS f32x4* vp = (const LAS f32x4*)(s_v + t * 256 + h * 64 + vq * 16);
#pragma unroll
                      for (int j = 0; j < 4; ++j) a4[j] += vp[j] * kd; }
                  float* dst = (smp ? GLS + (size_t)seq * 8192 : GL + (size_t)u * 8192) + (h * 32 + k) * 64 + vq * 16;
#pragma unroll
                  for (int j = 0; j < 4; ++j) ((f32x4*)dst)[j] = a4[j]; }
                __syncthreads();
                for (int i = tid; i < (ntok + 3) * 256; i += NTHR) { const int tt = i >> 8, c = i & 255; const int t = tt - 3; float v;
                    if (t >= 0) v = bf2f(PROJ[(size_t)(row0 + t) * NPROJ + PC_LX + c]);
                    else if (smp) v = args.in[I_SCONV][(((size_t)l * NBS + seq) * 3 + tt) * 256 + c];
                    else v = (ch_ == 0) ? 0.f : bf2f(PROJ[(size_t)(row0 + t) * NPROJ + PC_LX + c]);
                    s_lx[i] = v; }
                __syncthreads();
                if (smp || ch_ == 63) { for (int i = tid; i < 3 * 256; i += NTHR) { const int j = i >> 8, c = i & 255; const float v = s_lx[(ntok + j) * 256 + c];
                    if (smp) out[O_CONVS + (((size_t)l * NBS + seq) * 3 + j) * 256 + c] = v; else out[O_CONVP + (((size_t)l * NBP + seq) * 3 + j) * 256 + c] = v; } }
                { const int c = tid & 255, th = tid >> 8; const float w0 = args.in[I_CW][(l * 4 + 0) * 256 + c], w1 = args.in[I_CW][(l * 4 + 1) * 256 + c], w2 = args.in[I_CW][(l * 4 + 2) * 256 + c],
                      w3 = args.in[I_CW][(l * 4 + 3) * 256 + c], cb = args.in[I_CB][l * 256 + c];
                  for (int t = th; t < ntok; t += 2) s_xc[t * 256 + c] = cb + w0 * s_lx[t * 256 + c] + w1 * s_lx[(t + 1) * 256 + c] + w2 * s_lx[(t + 2) * 256 + c] + w3 * s_lx[(t + 3) * 256 + c]; }
                __syncthreads();
                { const int gate = tid >> 8, c = tid & 255, n = c >> 6, kc = c & 63; const float* Wg = (gate ? args.in[I_LWX] : args.in[I_LWA]) + ((size_t)(l * 4 + n) * 64) * 64 + kc;
                  const float bias = (gate ? args.in[I_LBX] : args.in[I_LBA])[l * 256 + c];
                  float w[64];
#pragma unroll
                  for (int j = 0; j < 64; ++j) w[j] = Wg[j * 64];
                  LAS float* dstg = gate ? s_i : s_r;
                  for (int t = 0; t < ntok; ++t) { float a = bias; const LAS f32x4* xp = (const LAS f32x4*)(s_xc + t * 256 + n * 64);
#pragma unroll
                      for (int j4 = 0; j4 < 16; ++j4) { const f32x4 x = xp[j4]; a += x[0] * w[4 * j4] + x[1] * w[4 * j4 + 1] + x[2] * w[4 * j4 + 2] + x[3] * w[4 * j4 + 3]; }
                      dstg[t * 256 + c] = sigmoidf_(a); } }
                __syncthreads();
                if (tid < 256) { const int c = tid; const float lam = args.in[I_LAM][l * 256 + c]; const float sp = fmaxf(-lam, 0.f) + log1pf(__expf(-fabsf(lam)));
                    float hh = 0.f, A = 1.f;
                    for (int t = 0; t < ntok; ++t) { const float la = -8.f * s_r[t * 256 + c] * sp; const float a = __expf(la); const float uu = sqrtf(-expm1f(2.f * la)) * (s_i[t * 256 + c] * s_xc[t * 256 + c]);
                        hh = a * hh + uu; A *= a; HLOC[(size_t)(row0 + t) * 256 + c] = hh; ACUM[(size_t)(row0 + t) * 256 + c] = A; }
                    AAGG[cidx * 256 + c] = A; HAGG[cidx * 256 + c] = hh; }
                __syncthreads();
            }
            }
        }
        PHASE_END

        PHASE_BEGIN
        {
            const int gt = blk * NTHR + tid, NGT = G * NTHR;
            constexpr int N_GP = NBP * 8192, N_GS = NBS * 8192, N_LP = NBP * 256, N_LS = NBS * 256;
            for (int it = gt; it < N_GP + N_GS + N_LP + N_LS; it += NGT) {
                if (it < N_GP) { const int seq = it >> 13, e = it & 8191, hk = e >> 6; float S = 0.f;
#pragma unroll 8
                    for (int c = 0; c < 64; ++c) { const size_t idx = ((size_t)(seq * 64 + c)) * 8192 + e; const float tmp = GL[idx]; const float d = GD[(size_t)(seq * 64 + c) * 128 + hk]; GL[idx] = S; S = d * S + tmp; }
                    out[O_GLAP + ((size_t)l * NBP + seq) * 8192 + e] = S;
                } else if (it < N_GP + N_GS) { const int j = it - N_GP, seq = j >> 13, e = j & 8191, hk = e >> 6; const float s0 = args.in[I_SGLA][((size_t)l * NBS + seq) * 8192 + e];
                    const float tmp = GLS[j]; GLS[j] = s0; out[O_GLAS + ((size_t)l * NBS + seq) * 8192 + e] = GDS[seq * 128 + hk] * s0 + tmp;
                } else if (it < N_GP + N_GS + N_LP) { const int j = it - N_GP - N_GS, seq = j >> 8, c = j & 255; float hh = 0.f;
#pragma unroll 8
                    for (int k = 0; k < 64; ++k) { const size_t idx = (size_t)(seq * 64 + k) * 256 + c; HIN[idx] = hh; hh = AAGG[idx] * hh + HAGG[idx]; }
                    out[O_LRUP + ((size_t)l * NBP + seq) * 256 + c] = hh;
                } else { const int j = it - N_GP - N_GS - N_LP, seq = j >> 8, c = j & 255; const size_t idx = (size_t)(512 + seq) * 256 + c; const float h0 = args.in[I_SLRU][((size_t)l * NBS + seq) * 256 + c];
                    HIN[idx] = h0; out[O_LRUS + ((size_t)l * NBS + seq) * 256 + c] = AAGG[idx] * h0 + HAGG[idx]; }
            }
            if (blk >= G - NBS) {
                const int b = G - 1 - blk; LAS float* s_q = (LAS float*)lds;
                LAS float* s_w = (LAS float*)(lds + 16384);
                for (int i = tid; i < 64 * 64; i += NTHR) { const int rr = i >> 6, n = i & 63, t = rr >> 3, h = rr & 7; s_q[i] = bf2f(QB[(size_t)(MP + b * TS + t) * 768 + h * 96 + n]); }
                for (int i = tid; i < 64 * 32; i += NTHR) { const int rr = i >> 5, p = i & 31, t = rr >> 3, h = rr & 7; const int d = (p >> 1) + 16 * (p & 1);
                    QLAT[(size_t)((b * TS + t) * 8 + h) * 160 + 128 + d] = QB[(size_t)(MP + b * TS + t) * 768 + h * 96 + 64 + p]; }
                for (int h = 0; h < 8; ++h) {
                    __syncthreads();
                    for (int i = tid; i < 128 * 64; i += NTHR) { const int lat = i >> 6, n = i & 63; s_w[lat * 65 + n] = args.in[I_WUK][((size_t)l * 128 + lat) * 512 + h * 64 + n]; }
                    __syncthreads();
                    for (int i = tid; i < 8 * 128; i += NTHR) { const int t = i >> 7, lat = i & 127; const LAS float* q = s_q + (t * 8 + h) * 64; float a = 0.f;
#pragma unroll 16
                        for (int n = 0; n < 64; ++n) a += q[n] * s_w[lat * 65 + n];
                        QLAT[(size_t)((b * TS + t) * 8 + h) * 160 + lat] = f2bf(a); }
                }
                __syncthreads();
            }
        }
        PHASE_END

        PHASE_BEGIN
        {
            const int g4 = lane >> 4, r16 = lane & 15, q4 = r16 >> 2, p4 = lane & 3;
            if (G == 256) {
                constexpr int KP = 208, VP = 144, VOFF = 64 * KP;
                const int bh = blk >> 2, jj = blk & 3, b = bh >> 3, h = bh & 7; const size_t rowbase = (size_t)b * SEQ;
                for (int ui = 0; ui < 4; ++ui) {
                    const int qb = (ui == 0) ? 2 * jj : (ui == 1) ? 2 * jj + 1 : (ui == 2) ? 15 - 2 * jj : 14 - 2 * jj;
                    const int q0 = qb * 128 + wid * 16; const int ntile = 2 * (qb + 1);
                    bf16x8 qf[3];
#pragma unroll
                    for (int ks = 0; ks < 3; ++ks) qf[ks] = *(const bf16x8*)(QB + (rowbase + q0 + r16) * 768 + h * 96 + ks * 32 + g4 * 8);
                    float mrun = -INFINITY, lsum = 0.f; f32x4 o[4];
#pragma unroll
                    for (int c = 0; c < 4; ++c) o[c] = (f32x4){0.f, 0.f, 0.f, 0.f};
                    for (int t = 0; t < ntile; ++t) {
                        const int k0 = t * 64;
                        __syncthreads();
                        { const int row = tid >> 3, ch = tid & 7; const u32x4 v = *(const u32x4*)(VB + (rowbase + k0 + row) * 512 + h * 64 + ch * 8); *(LAS u32x4*)(lds + VOFF + row * VP + ch * 16) = v;
                          for (int idx = tid; idx < 768; idx += NTHR) { const int kr = idx / 12, kc = idx % 12; const u32x4 kv = *(const u32x4*)(KB + (rowbase + k0 + kr) * 768 + h * 96 + kc * 8); *(LAS u32x4*)(lds + kr * KP + kc * 16) = kv; } }
                        __syncthreads();
                        f32x4 s[4];
#pragma unroll
                        for (int jt = 0; jt < 4; ++jt) { s[jt] = (f32x4){0.f, 0.f, 0.f, 0.f};
#pragma unroll
                            for (int ks = 0; ks < 3; ++ks) { const bf16x8 kf = *(const LAS bf16x8*)(lds + (16 * jt + r16) * KP + (ks * 32 + g4 * 8) * 2); s[jt] = mfma16(kf, qf[ks], s[jt]); } }
                        if (t >= ntile - 2) {
#pragma unroll
                            for (int jt = 0; jt < 4; ++jt)
#pragma unroll
                                for (int i = 0; i < 4; ++i) if (k0 + 16 * jt + 4 * g4 + i > q0 + r16) s[jt][i] = -INFINITY; }
                        float mx = fmaxf(fmaxf(s[0][0], s[0][1]), fmaxf(s[0][2], s[0][3]));
#pragma unroll
                        for (int jt = 1; jt < 4; ++jt) mx = fmaxf(mx, fmaxf(fmaxf(s[jt][0], s[jt][1]), fmaxf(s[jt][2], s[jt][3])));
                        mx = fmaxf(mx, __shfl_xor(mx, 16)); mx = fmaxf(mx, __shfl_xor(mx, 32));
                        const float mnew = fmaxf(mrun, mx); const float alpha = exp2f(mrun - mnew); mrun = mnew;
                        float ps = 0.f;
#pragma unroll
                        for (int jt = 0; jt < 4; ++jt)
#pragma unroll
                            for (int i = 0; i < 4; ++i) { s[jt][i] = exp2f(s[jt][i] - mnew); ps += s[jt][i]; }
                        lsum = lsum * alpha + ps;
#pragma unroll
                        for (int c = 0; c < 4; ++c) o[c] = o[c] * alpha;
#pragma unroll
                        for (int ks = 0; ks < 2; ++ks) { u32x4 pw; pw.x = pk2(s[2 * ks][0], s[2 * ks][1]); pw.y = pk2(s[2 * ks][2], s[2 * ks][3]); pw.z = pk2(s[2 * ks + 1][0], s[2 * ks + 1][1]); pw.w = pk2(s[2 * ks + 1][2], s[2 * ks + 1][3]);
                            const bf16x8 pf = __builtin_bit_cast(bf16x8, pw);
#pragma unroll
                            for (int c = 0; c < 4; ++c) { const LAS unsigned char* vp = lds + VOFF + (32 * ks + 4 * g4 + q4) * VP + (16 * c + 4 * p4) * 2;
                                const s16x4 lo = vtr(vp), hi = vtr(vp + 16 * VP); const bf16x8 vf = (bf16x8){lo[0], lo[1], lo[2], lo[3], hi[0], hi[1], hi[2], hi[3]};
                                o[c] = mfma16(vf, pf, o[c]); } }
                    }
                    lsum += __shfl_xor(lsum, 16); lsum += __shfl_xor(lsum, 32);
                    const float inv = 1.f / lsum;
#pragma unroll
                    for (int c = 0; c < 4; ++c) { u32x2 w; w.x = pk2(o[c][0] * inv, o[c][1] * inv); w.y = pk2(o[c][2] * inv, o[c][3] * inv);
                        *(u32x2*)(MIX + (rowbase + q0 + r16) * DM + 512 + h * 64 + 16 * c + 4 * g4) = w; }
                }
                __syncthreads();
                {
                    FRESH_TID const int g4 = lane >> 4, r16 = lane & 15, q4 = r16 >> 2, p4 = lane & 3;
                    constexpr int PP = 336;
                    const int b = blk >> 3, sp = blk & 7, qt = wid & 3, half = wid >> 2;
                    bf16x8 qf[5];
                    { const int rr = qt * 16 + r16;
#pragma unroll
                      for (int ks = 0; ks < 5; ++ks) qf[ks] = *(const bf16x8*)(QLAT + (size_t)(b * 64 + rr) * 160 + ks * 32 + g4 * 8); }
                    float mrun = -INFINITY, lsum = 0.f; f32x4 o[8];
#pragma unroll
                    for (int c = 0; c < 8; ++c) o[c] = (f32x4){0.f, 0.f, 0.f, 0.f};
                    const int* pt = args.page_table + b * NPAGES + sp * 16;
                    f32x4 pre[10];
                    { const size_t ph = (size_t)pt[0]; const float* cp = args.in[I_CCKV] + ((size_t)l * NPHYS + ph) * PAGE * 128; const float* kp = args.in[I_CKR] + ((size_t)l * NPHYS + ph) * PAGE * 32;
#pragma unroll
                      for (int j = 0; j < 8; ++j) pre[j] = *(const f32x4*)(cp + (size_t)(tid + NTHR * j) * 4);
#pragma unroll
                      for (int j = 0; j < 2; ++j) pre[8 + j] = *(const f32x4*)(kp + (size_t)(tid + NTHR * j) * 4); }
                    for (int pg = 0; pg < 16; ++pg) {
                        __syncthreads();
#pragma unroll
                        for (int j = 0; j < 8; ++j) { const int idx = tid + NTHR * j, key = idx >> 5, c4 = idx & 31; u32x2 w; w.x = pk2(pre[j][0], pre[j][1]); w.y = pk2(pre[j][2], pre[j][3]); *(LAS u32x2*)(lds + key * PP + c4 * 8) = w; }
#pragma unroll
                        for (int j = 0; j < 2; ++j) { const int idx = tid + NTHR * j, key = idx >> 3, c4 = idx & 7; u32x2 w; w.x = pk2(pre[8 + j][0], pre[8 + j][1]); w.y = pk2(pre[8 + j][2], pre[8 + j][3]); *(LAS u32x2*)(lds + key * PP + 256 + c4 * 8) = w; }
                        __syncthreads();
                        if (pg + 1 < 16) { const size_t ph = (size_t)pt[pg + 1]; const float* cp = args.in[I_CCKV] + ((size_t)l * NPHYS + ph) * PAGE * 128; const float* kp = args.in[I_CKR] + ((size_t)l * NPHYS + ph) * PAGE * 32;
#pragma unroll
                            for (int j = 0; j < 8; ++j) pre[j] = *(const f32x4*)(cp + (size_t)(tid + NTHR * j) * 4);
#pragma unroll
                            for (int j = 0; j < 2; ++j) pre[8 + j] = *(const f32x4*)(kp + (size_t)(tid + NTHR * j) * 4); }
                        const LAS unsigned char* kb = lds + (64 * half) * PP;
                        f32x4 s[4];
#pragma unroll
                        for (int jt = 0; jt < 4; ++jt) { s[jt] = (f32x4){0.f, 0.f, 0.f, 0.f};
#pragma unroll
                            for (int ks = 0; ks < 5; ++ks) { const bf16x8 kf = *(const LAS bf16x8*)(kb + (16 * jt + r16) * PP + (ks * 32 + g4 * 8) * 2); s[jt] = mfma16(kf, qf[ks], s[jt]); } }
                        float mx = fmaxf(fmaxf(s[0][0], s[0][1]), fmaxf(s[0][2], s[0][3]));
#pragma unroll
                        for (int jt = 1; jt < 4; ++jt) mx = fmaxf(mx, fmaxf(fmaxf(s[jt][0], s[jt][1]), fmaxf(s[jt][2], s[jt][3])));
                        mx = fmaxf(mx, __shfl_xor(mx, 16)); mx = fmaxf(mx, __shfl_xor(mx, 32));
                        const float mnew = fmaxf(mrun, mx); const float alpha = exp2f(mrun - mnew); mrun = mnew;
                        float ps = 0.f;
#pragma unroll
                        for (int jt = 0; jt < 4; ++jt)
#pragma unroll
                            for (int i = 0; i < 4; ++i) { s[jt][i] = exp2f(s[jt][i] - mnew); ps += s[jt][i]; }
                        lsum = lsum * alpha + ps;
#pragma unroll
                        for (int c = 0; c < 8; ++c) o[c] = o[c] * alpha;
#pragma unroll
                        for (int ks = 0; ks < 2; ++ks) { u32x4 pw; pw.x = pk2(s[2 * ks][0], s[2 * ks][1]); pw.y = pk2(s[2 * ks][2], s[2 * ks][3]); pw.z = pk2(s[2 * ks + 1][0], s[2 * ks + 1][1]); pw.w = pk2(s[2 * ks + 1][2], s[2 * ks + 1][3]);
                            const bf16x8 pf = __builtin_bit_cast(bf16x8, pw);
#pragma unroll
                            for (int c = 0; c < 8; ++c) { const LAS unsigned char* vp = kb + (32 * ks + 4 * g4 + q4) * PP + (16 * c + 4 * p4) * 2;
                                const s16x4 lo = vtr(vp), hi = vtr(vp + 16 * PP); const bf16x8 vf = (bf16x8){lo[0], lo[1], lo[2], lo[3], hi[0], hi[1], hi[2], hi[3]};
                                o[c] = mfma16(vf, pf, o[c]); } }
                    }
                    lsum += __shfl_xor(lsum, 16); lsum += __shfl_xor(lsum, 32);
                    const int part = sp * 2 + half; const size_t prow = ((size_t)(b * 16 + part) * 64 + qt * 16 + r16);
#pragma unroll
                    for (int c = 0; c < 8; ++c) *(f32x4*)(PO + prow * 128 + 16 * c + 4 * g4) = o[c];
                    if (g4 == 0) { PML[prow * 2] = mrun; PML[prow * 2 + 1] = lsum; }
                    __syncthreads();
                }
            }
            {
                FRESH_TID
                constexpr int QP = 132;
                LAS float* s_qt = (LAS float*)(lds);
                LAS float* s_kt = (LAS float*)(lds + 16896);
                LAS float* s_v = (LAS float*)(lds + 33792);
                LAS float* s_S = (LAS float*)(lds + 66560);
                LAS float* s_at = (LAS float*)(lds + 99328);
                for (int u = blk; u < 512 + NBS; u += G) {
                    FRESH_TID
                    const bool smp = u >= 512; const int seq = smp ? u - 512 : u >> 6, ch_ = smp ? 0 : u & 63; const int ntok = smp ? TS : 32;
                    const int row0 = smp ? MP + seq * TS : seq * SEQ + ch_ * 32; const size_t cidx = smp ? (size_t)(512 + seq) : (size_t)u;
                    __syncthreads();
                    for (int i = tid; i < 32 * 128; i += NTHR) { const int t = i >> 7, c = i & 127; float qv = 0.f, kv = 0.f;
                        if (t < ntok) { const float bc = BCUM[(size_t)(row0 + t) * 128 + c]; qv = bf2f(PROJ[(size_t)(row0 + t) * NPROJ + PC_GQ + c]) * GLA_SCALE * __expf(bc); kv = bf2f(PROJ[(size_t)(row0 + t) * NPROJ + PC_GK + c]) * __expf(-bc); }
                        s_qt[t * QP + c] = qv; s_kt[t * QP + c] = kv; }
                    for (int i = tid; i < 32 * 256; i += NTHR) { const int t = i >> 8, c = i & 255; s_v[i] = t < ntok ? bf2f(PROJ[(size_t)(row0 + t) * NPROJ + PC_GV + c]) : 0.f; }
                    { const float* Sp = smp ? GLS + (size_t)seq * 8192 : GL + (size_t)u * 8192; for (int i = tid; i < 8192; i += NTHR) s_S[i] = Sp[i]; }
                    __syncthreads();
                    { const int h = tid >> 7, t = (tid & 127) >> 2, sg = tid & 3; float a[8];
#pragma unroll
                      for (int j = 0; j < 8; ++j) a[j] = 0.f;
                      for (int k = 0; k < 32; ++k) { const float qv = s_qt[t * QP + h * 32 + k];
#pragma unroll
                          for (int j = 0; j < 8; ++j) a[j] += qv * s_kt[(sg * 8 + j) * QP + h * 32 + k]; }
#pragma unroll
                      for (int j = 0; j < 8; ++j) s_at[(h * 32 + t) * 33 + sg * 8 + j] = (sg * 8 + j <= t) ? a[j] : 0.f; }
                    __syncthreads();
                    { const int h = tid >> 7, t = (tid & 127) >> 2, vq = tid & 3; f32x4 a4[4];
#pragma unroll
                      for (int j = 0; j < 4; ++j) a4[j] = (f32x4){0.f, 0.f, 0.f, 0.f};
                      for (int s = 0; s < 32; ++s) { const float w = s_at[(h * 32 + t) * 33 + s]; const LAS f32x4* vp = (const LAS f32x4*)(s_v + s * 256 + h * 64 + vq * 16);
#pragma unroll
                          for (int j = 0; j < 4; ++j) a4[j] += vp[j] * w; }
                      for (int k = 0; k < 32; ++k) { const float w = s_qt[t * QP + h * 32 + k]; const LAS f32x4* sp_ = (const LAS f32x4*)(s_S + (h * 32 + k) * 64 + vq * 16);
#pragma unroll
                          for (int j = 0; j < 4; ++j) a4[j] += sp_[j] * w; }
                      float ss = 0.f;
#pragma unroll
                      for (int j = 0; j < 4; ++j) ss += (a4[j][0] * a4[j][0] + a4[j][1] * a4[j][1]) + (a4[j][2] * a4[j][2] + a4[j][3] * a4[j][3]);
                      ss += __shfl_xor(ss, 1); ss += __shfl_xor(ss, 2);
                      const float rinv = rsqrtf(ss * (1.f / 64.f) + RMS_EPS);
                      if (t < ntok) { const int r = row0 + t; const bf16* gp = PROJ + (size_t)r * NPROJ + PC_GG + h * 64 + vq * 16; const float* gn = args.in[I_GNG] + l * 64 + vq * 16; unsigned wv[8];
#pragma unroll
                          for (int j = 0; j < 4; ++j) { float o4[4];
#pragma unroll
                              for (int e = 0; e < 4; ++e) o4[e] = a4[j][e] * rinv * gn[4 * j + e] * siluf_(bf2f(gp[4 * j + e]));
                              wv[2 * j] = pk2(o4[0], o4[1]); wv[2 * j + 1] = pk2(o4[2], o4[3]); }
                          bf16* dst = MIX + (size_t)r * DM + h * 64 + vq * 16;
                          *(u32x4*)dst = (u32x4){wv[0], wv[1], wv[2], wv[3]}; *(u32x4*)(dst + 8) = (u32x4){wv[4], wv[5], wv[6], wv[7]}; } }
                    { const int c = tid & 255, th = tid >> 8; const float hin = HIN[cidx * 256 + c];
                      for (int t = th; t < ntok; t += 2) { const int r = row0 + t; const float hh = HLOC[(size_t)r * 256 + c] + ACUM[(size_t)r * 256 + c] * hin;
                          MIX[(size_t)r * DM + 256 + c] = f2bf(gelu_tanh(bf2f(PROJ[(size_t)r * NPROJ + PC_LG + c])) * hh); } }
                }
                __syncthreads();
            }
        }
        PHASE_END

        PHASE_BEGIN
        {
            if (blk < NBS) {
                const int b = blk; LAS float* s_o = (LAS float*)lds;
                LAS float* s_ck = (LAS float*)(lds + 32768);
                LAS float* s_kr = (LAS float*)(lds + 32768 + 4096);
                LAS float* s_p = (LAS float*)(lds + 32768 + 4096 + 1024);
                LAS float* s_w = (LAS float*)(lds + 32768 + 4096 + 1024 + 2048);
                for (int i = tid; i < 8 * 128; i += NTHR) s_ck[i] = out[O_CKVS + ((size_t)l * NBS + b) * TS * 128 + i];
                for (int i = tid; i < 8 * 32; i += NTHR) s_kr[i] = out[O_KRS + ((size_t)l * NBS + b) * TS * 32 + i];
                __syncthreads();
                { const int rr = tid >> 3, j = tid & 7, t = rr >> 3; const bf16* q = QLAT + (size_t)(b * 64 + rr) * 160; float a = 0.f;
                  for (int d = 0; d < 128; ++d) a += bf2f(q[d]) * s_ck[j * 128 + d];
                  for (int d = 0; d < 32; ++d) a += bf2f(q[128 + d]) * s_kr[j * 32 + d];
                  s_p[rr * 8 + j] = (j <= t) ? a : -INFINITY; }
                __syncthreads();
                if (tid < 64) { const int rr = tid; float m = -INFINITY;
                    for (int p = 0; p < 16; ++p) m = fmaxf(m, PML[((size_t)(b * 16 + p) * 64 + rr) * 2]);
                    for (int j = 0; j < 8; ++j) m = fmaxf(m, s_p[rr * 8 + j]);
                    float lt = 0.f;
                    for (int p = 0; p < 16; ++p) { const float w = exp2f(PML[((size_t)(b * 16 + p) * 64 + rr) * 2] - m); s_w[rr * 16 + p] = w; lt += w * PML[((size_t)(b * 16 + p) * 64 + rr) * 2 + 1]; }
                    for (int j = 0; j < 8; ++j) { const float w = exp2f(s_p[rr * 8 + j] - m); s_p[rr * 8 + j] = w; lt += w; }
                    s_w[1024 + rr] = 1.f / lt; }
                __syncthreads();
                for (int i = tid; i < 64 * 128; i += NTHR) { const int rr = i >> 7, d = i & 127; float a = 0.f;
                    for (int p = 0; p < 16; ++p) a += s_w[rr * 16 + p] * PO[((size_t)(b * 16 + p) * 64 + rr) * 128 + d];
                    for (int j = 0; j < 8; ++j) a += s_p[rr * 8 + j] * s_ck[j * 128 + d];
                    s_o[i] = a * s_w[1024 + rr]; }
                __syncthreads();
                { const int rr = tid >> 3, vg = tid & 7, t = rr >> 3, h = rr & 7; float a[8];
#pragma unroll
                  for (int e = 0; e < 8; ++e) a[e] = 0.f;
                  for (int d = 0; d < 128; ++d) { const float ov = s_o[rr * 128 + d]; const float* wp = args.in[I_WUV] + ((size_t)l * 128 + d) * 512 + h * 64 + vg * 8; const f32x4 w0 = *(const f32x4*)wp, w1 = *(const f32x4*)(wp + 4);
                      a[0] += ov * w0[0]; a[1] += ov * w0[1]; a[2] += ov * w0[2]; a[3] += ov * w0[3]; a[4] += ov * w1[0]; a[5] += ov * w1[1]; a[6] += ov * w1[2]; a[7] += ov * w1[3]; }
                  *(u32x4*)(MIX + (size_t)(MP + b * TS + t) * DM + 512 + h * 64 + vg * 8) = (u32x4){pk2(a[0], a[1]), pk2(a[2], a[3]), pk2(a[4], a[5]), pk2(a[6], a[7])}; }
                __syncthreads();
            }
        }
        PHASE_END

        PHASE_BEGIN
        {
            pg8::Gemm g{MIX, WOUT + (size_t)l * DM * DM, MT, DM, DM, DM, DM}; pg8::StaticOrder S; S.init(MT, DM, G, blk);
            pg8::EpiRes E{X, ADAl + 2048}; pg8::gemm_phase<pg8::EpiRes, true>(lds, g, S, E, tid);
        }
        PHASE_END
        PHASE_BEGIN
        {
            const int gw = blk * NWAVES + wid, NGW = G * NWAVES;
            for (int r = gw; r < MT; r += NGW) { const float* ad = ADAl + (size_t)row_bi(r) * 6144; float* xr = X + (size_t)r * DM;
                ln_row(xr, args.in[I_LN1G] + l * DM, args.in[I_LN1B] + l * DM, xr, H + (size_t)r * DM, ad + 4096, ad + 3072, lane); }
        }
        PHASE_END
        PHASE_BEGIN
        {
            pg8::Gemm g{H, WGU + (size_t)l * 2 * DFF * DM, MT, 2 * DFF, DM, DM, DM}; pg8::StaticOrder S; S.init(MT, 2 * DFF, G, blk);
            pg8::EpiSwi E{FB}; pg8::gemm_phase<pg8::EpiSwi, true>(lds, g, S, E, tid);
        }
        PHASE_END
        PHASE_BEGIN
        {
            pg8::Gemm g{FB, WDN + (size_t)l * DM * DFF, MT, DM, DFF, DFF, DFF}; pg8::StaticOrder S; S.init(MT, DM, G, blk);
            pg8::EpiRes E{X, ADAl + 5120}; pg8::gemm_phase<pg8::EpiRes, true>(lds, g, S, E, tid);
        }
        PHASE_END
        PHASE_BEGIN
        {
            const int gw = blk * NWAVES + wid, NGW = G * NWAVES; const bool lastl = (l == DEPTH - 1);
            for (int r = gw; r < MT; r += NGW) { const float* ad = ADA + ((size_t)(lastl ? l : l + 1) * NBI + row_bi(r)) * 6144; float* xr = X + (size_t)r * DM;
                ln_row(xr, args.in[I_LN2G] + l * DM, args.in[I_LN2B] + l * DM, lastl ? out + O_YP + (size_t)r * DM : xr, lastl ? (bf16*)nullptr : H + (size_t)r * DM, ad + 1024, ad, lane); }
        }
        PHASE_END
    }
#undef PHASE_BEGIN
#undef PHASE_END
}

constexpr int N_PHASES = 3 + DEPTH * 10;
extern "C" void kernel_launch(void* const* d_in, const int* in_sizes, int n_in, void* d_out, int out_size, void* d_ws, size_t ws_size, hipStream_t stream) {
    static int grid = 0;
    if (grid == 0) {
        if (n_in != 37 || (size_t)out_size != O_END || ws_size < WS_END) { fprintf(stderr, "kernel_launch: unexpected shapes: n_in %d out %d ws %zu\n", n_in, out_size, ws_size); grid = -1; return; }
        if (hipFuncSetAttribute((const void*)fwd, hipFuncAttributeMaxDynamicSharedMemorySize, LDS_BYTES) != hipSuccess) { fprintf(stderr, "kernel_launch: hipFuncSetAttribute failed\n"); grid = -1; return; }
        int dev = 0, cus = 0; (void)hipGetDevice(&dev); (void)hipDeviceGetAttribute(&cus, hipDeviceAttributeMultiprocessorCount, dev);
        (void)hipGetLastError();
        grid = 256;
        if (cus != 256) fprintf(stderr, "kernel_launch: note: %d CUs reported; this kernel is built for a 256-workgroup grid\n", cus);
    }
    if (grid < 0) return;
    (void)hipMemsetAsync((char*)d_ws + WS_CTL, 0, CTL_ZERO_BYTES, stream);
    Args a{};
    for (int i = 0; i < 37; ++i) a.in[i] = (const float*)d_in[i];
    a.page_table = (const int*)d_in[I_PT]; a.out = (float*)d_out; a.ws = (unsigned char*)d_ws;
#ifndef MK_PER_PHASE
    a.ph_lo = 0; a.ph_hi = N_PHASES;
    hipLaunchKernelGGL(fwd, dim3(grid), dim3(NTHR), LDS_BYTES, stream, a);
#else
    for (int p = 0; p < N_PHASES; ++p) { a.ph_lo = p; a.ph_hi = p + 1; hipLaunchKernelGGL(fwd, dim3(grid), dim3(NTHR), LDS_BYTES, stream, a); }
#endif
}
```
